# Optimizing an MI355X kernel written in HIP

```python
import math
import jax, jax.numpy as jnp
from jax import lax
import numpy as np

D_MODEL = 1024
BATCH = 8
SEQ = 2048
DEPTH = 2

D_MIX = D_MODEL
D_A = D_MIX // 2
N_HEADS_A = 8
HEAD_DIM_A = D_A // N_HEADS_A
CHUNK = 128
D_B = D_MIX - D_A
N_GROUPS_B = 8
HYENA_ORDER = 2
N_PROJ_B = HYENA_ORDER + 1
SHORT_K = 3
IN_COLS = 2 * D_A + N_PROJ_B * D_B
FILTER_EMB = 33
FILTER_BANDS = (FILTER_EMB - 1) // 2
FILTER_WIDTH = 64
FILTER_OUT_SCALE = 0.1
DECAY_TARGET = 1e-2
FAST_DECAY_PCT = 0.3
SLOW_DECAY_PCT = 1.5
MAX_DECAY = math.log(DECAY_TARGET) / FAST_DECAY_PCT
MIN_DECAY = math.log(DECAY_TARGET) / SLOW_DECAY_PCT
D_FF = 2816
HALF_STEP = 0.5
RMS_EPS = 1e-6
LN_EPS = 1e-5

kernel_name = 'hybrid_gmlp_hyena_macaron_encoder'


def _rms_norm(x, g):
    xf = x.astype(jnp.float32)
    y = xf * lax.rsqrt(jnp.mean(jnp.square(xf), axis=-1, keepdims=True) + RMS_EPS)
    return (y * g.astype(jnp.float32)).astype(x.dtype)


def _layer_norm(x, g, b):
    xf = x.astype(jnp.float32)
    mu = jnp.mean(xf, axis=-1, keepdims=True)
    var = jnp.mean(jnp.square(xf - mu), axis=-1, keepdims=True)
    y = (xf - mu) * lax.rsqrt(var + LN_EPS)
    return (y * g.astype(jnp.float32) + b.astype(jnp.float32)).astype(x.dtype)


def _swiglu(h, w_gate, w_up, w_down):
    return (jax.nn.silu(h @ w_gate) * (h @ w_up)) @ w_down


def _spatial_gating(u, v, ln_g, ln_b, w_s, b_s):
    bsz, seq, _ = v.shape
    vn = _layer_norm(v, ln_g, ln_b).reshape(bsz, seq // CHUNK, CHUNK, N_HEADS_A, HEAD_DIM_A)
    mixed = jnp.einsum('hmc,bnchd->bnmhd', w_s, vn) + b_s.T[:, :, None]
    return u * mixed.reshape(bsz, seq, D_A)


def _short_conv(z, w, b):
    seq = z.shape[1]
    pad = SHORT_K // 2
    zp = jnp.pad(z, ((0, 0), (pad, pad), (0, 0)))
    out = b
    for k in range(SHORT_K):
        out = out + zp[:, k:k + seq] * w[k]
    return out


def _hyena_filter_spectrum(seq, w1, b1, w2, b2, w3, b3, freq, w_o):
    t = jnp.linspace(0.0, 1.0, seq, dtype=jnp.float32)[:, None]
    bands = jnp.linspace(1e-4, FILTER_BANDS - 1, FILTER_BANDS, dtype=jnp.float32)
    ang = (2.0 * math.pi / seq) * jnp.arange(seq, dtype=jnp.float32)[:, None] * bands[None, :]
    z = jnp.concatenate([t, jnp.cos(ang), -jnp.sin(ang)], axis=-1)
    h = jnp.sin(freq * (z @ w1 + b1))
    h = jnp.sin(freq * (h @ w2 + b2))
    h = jnp.sin(freq * (h @ w3 + b3))
    h = (h @ w_o).astype(jnp.float32).reshape(seq, HYENA_ORDER, 2, D_B)
    deltas = jnp.abs(jnp.linspace(MIN_DECAY, MAX_DECAY, D_B, dtype=jnp.float32))
    h = h * jnp.exp(-t * deltas)[:, None, None, :]
    fwd, bwd = h[:, :, 0], h[:, :, 1]
    k = jnp.concatenate([fwd, jnp.zeros_like(fwd[:1]), bwd[:0:-1]], axis=0)
    return jnp.fft.rfft(k, axis=0)


def _long_conv(u, k_f, skip):
    seq = u.shape[1]
    uf32 = u.astype(jnp.float32)
    y = jnp.fft.irfft(jnp.fft.rfft(uf32, n=2 * seq, axis=1) * k_f[None], n=2 * seq, axis=1)[:, :seq]
    return (y + uf32 * skip.astype(jnp.float32)).astype(u.dtype)


def _hyena(p, k_f, skip):
    parts = jnp.split(p, N_PROJ_B, axis=-1)
    z = parts[0]
    for n in range(HYENA_ORDER):
        z = parts[n + 1] * _long_conv(z, k_f[:, n], skip[n])
    return z


def _token_mix(h, w_in, ln_g, ln_b, w_s, b_s, conv_w, conv_b, fw1, fb1, fw2, fb2, fw3, fb3,
               ffreq, fwo, skip, w_out):
    p = h @ w_in
    u_a, v_a = jnp.split(jax.nn.gelu(p[..., :2 * D_A], approximate=False), 2, axis=-1)
    y_a = _spatial_gating(u_a, v_a, ln_g, ln_b, w_s, b_s)
    p_b = _short_conv(p[..., 2 * D_A:], conv_w, conv_b)
    k_f = _hyena_filter_spectrum(h.shape[1], fw1, fb1, fw2, fb2, fw3, fb3, ffreq, fwo)
    y_b = _hyena(p_b, k_f, skip)
    return jnp.concatenate([y_a, y_b], axis=-1) @ w_out


def setup_inputs(seed: int = 0) -> dict:
    key = jax.random.key(seed)
    ks = iter(jax.random.split(key, 40))

    def nrm(shape, scale):
        return jax.random.normal(next(ks), shape, jnp.float32) * scale

    def gain(shape):
        return 1.0 + nrm(shape, 0.05)

    L = DEPTH
    return {
        'x': nrm((BATCH, SEQ, D_MODEL), 1.0),
        'ffn1_pre_g': gain((L, D_MODEL)),
        'ffn1_w_gate': nrm((L, D_MODEL, D_FF), D_MODEL ** -0.5),
        'ffn1_w_up': nrm((L, D_MODEL, D_FF), D_MODEL ** -0.5),
        'ffn1_w_down': nrm((L, D_FF, D_MODEL), D_FF ** -0.5),
        'ffn1_post_g': gain((L, D_MODEL)),
        'mix_pre_g': gain((L, D_MODEL)),
        'mix_w_in': nrm((L, D_MODEL, IN_COLS), D_MODEL ** -0.5),
        'gmlp_ln_g': gain((L, D_A)),
        'gmlp_ln_b': nrm((L, D_A), 0.02),
        'gmlp_w_s': nrm((L, N_HEADS_A, CHUNK, CHUNK), CHUNK ** -0.5),
        'gmlp_b_s': gain((L, N_HEADS_A, CHUNK)),
        'hy_conv_w': nrm((L, SHORT_K, N_PROJ_B * D_B), SHORT_K ** -0.5),
        'hy_conv_b': nrm((L, N_PROJ_B * D_B), 0.02),
        'hy_filt_w1': nrm((L, FILTER_EMB, FILTER_WIDTH), FILTER_EMB ** -0.5),
        'hy_filt_b1': nrm((L, FILTER_WIDTH), 0.1),
        'hy_filt_w2': nrm((L, FILTER_WIDTH, FILTER_WIDTH), FILTER_WIDTH ** -0.5),
        'hy_filt_b2': nrm((L, FILTER_WIDTH), 0.1),
        'hy_filt_w3': nrm((L, FILTER_WIDTH, FILTER_WIDTH), FILTER_WIDTH ** -0.5),
        'hy_filt_b3': nrm((L, FILTER_WIDTH), 0.1),
        'hy_filt_freq': gain((L, FILTER_WIDTH)),
        'hy_filt_w_out': nrm((L, FILTER_WIDTH, HYENA_ORDER * 2 * D_B), FILTER_OUT_SCALE * FILTER_WIDTH ** -0.5),
        'hy_skip': nrm((L, HYENA_ORDER, D_B), 0.5),
        'mix_w_out': nrm((L, D_MIX, D_MODEL), D_MIX ** -0.5),
        'mix_post_g': gain((L, D_MODEL)),
        'ffn2_pre_g': gain((L, D_MODEL)),
        'ffn2_w_gate': nrm((L, D_MODEL, D_FF), D_MODEL ** -0.5),
        'ffn2_w_up': nrm((L, D_MODEL, D_FF), D_MODEL ** -0.5),
        'ffn2_w_down': nrm((L, D_FF, D_MODEL), D_FF ** -0.5),
        'ffn2_post_g': gain((L, D_MODEL)),
    }


def reference(x, ffn1_pre_g, ffn1_w_gate, ffn1_w_up, ffn1_w_down, ffn1_post_g,
              mix_pre_g, mix_w_in, gmlp_ln_g, gmlp_ln_b, gmlp_w_s, gmlp_b_s,
              hy_conv_w, hy_conv_b, hy_filt_w1, hy_filt_b1, hy_filt_w2, hy_filt_b2,
              hy_filt_w3, hy_filt_b3, hy_filt_freq, hy_filt_w_out, hy_skip,
              mix_w_out, mix_post_g,
              ffn2_pre_g, ffn2_w_gate, ffn2_w_up, ffn2_w_down, ffn2_post_g):
    for l in range(DEPTH):
        h = _rms_norm(x, ffn1_pre_g[l])
        x = x + HALF_STEP * _rms_norm(_swiglu(h, ffn1_w_gate[l], ffn1_w_up[l], ffn1_w_down[l]), ffn1_post_g[l])
        h = _rms_norm(x, mix_pre_g[l])
        y = _token_mix(h, mix_w_in[l], gmlp_ln_g[l], gmlp_ln_b[l], gmlp_w_s[l], gmlp_b_s[l],
                       hy_conv_w[l], hy_conv_b[l], hy_filt_w1[l], hy_filt_b1[l],
                       hy_filt_w2[l], hy_filt_b2[l], hy_filt_w3[l], hy_filt_b3[l],
                       hy_filt_freq[l], hy_filt_w_out[l], hy_skip[l], mix_w_out[l])
        x = x + _rms_norm(y, mix_post_g[l])
        h = _rms_norm(x, ffn2_pre_g[l])
        x = x + HALF_STEP * _rms_norm(_swiglu(h, ffn2_w_gate[l], ffn2_w_up[l], ffn2_w_down[l]), ffn2_post_g[l])
    return x
```

```cpp
#include <hip/hip_runtime.h>
#include <cstddef>
namespace nv {
constexpr int T_ = 16384, D_ = 1024, FF_ = 2816, INC_ = 2560, SEQ_ = 2048, DA_ = 512, DB_ = 512, CH_ = 4096;

__global__ void gemm(const float* __restrict__ A, int lda, const float* __restrict__ B, int ldb, float* __restrict__ C, int ldc, int K) {
    __shared__ float As[16][65], Bs[16][64];
    const int tx = threadIdx.x & 15, ty = threadIdx.x >> 4, m0 = blockIdx.y * 64, n0 = blockIdx.x * 64;
    float acc[4][4] = {};
    for (int k0 = 0; k0 < K; k0 += 16) {
        for (int i = threadIdx.x; i < 64 * 16; i += 256) { int r = i >> 4, c = i & 15; As[c][r] = A[(size_t)(m0 + r) * lda + k0 + c]; }
        for (int i = threadIdx.x; i < 16 * 64; i += 256) { int r = i >> 6, c = i & 63; Bs[r][c] = B[(size_t)(k0 + r) * ldb + n0 + c]; }
        __syncthreads();
#pragma unroll
        for (int k = 0; k < 16; ++k) {
            float a[4], b[4];
#pragma unroll
            for (int i = 0; i < 4; ++i) { a[i] = As[k][ty * 4 + i]; b[i] = Bs[k][tx * 4 + i]; }
#pragma unroll
            for (int i = 0; i < 4; ++i)
#pragma unroll
                for (int j = 0; j < 4; ++j) acc[i][j] += a[i] * b[j];
        }
        __syncthreads();
    }
#pragma unroll
    for (int i = 0; i < 4; ++i)
#pragma unroll
        for (int j = 0; j < 4; ++j) C[(size_t)(m0 + ty * 4 + i) * ldc + n0 + tx * 4 + j] = acc[i][j];
}
__device__ __forceinline__ float wsum(float v) {
#pragma unroll
    for (int o = 1; o < 64; o <<= 1) v += __shfl_xor(v, o);
    return v;
}
__global__ void rmsnorm(const float* __restrict__ x, const float* __restrict__ g, float* __restrict__ out, float* __restrict__ res, float scale, int rows) {
    const int row = blockIdx.x * 4 + (threadIdx.x >> 6), lane = threadIdx.x & 63; if (row >= rows) return;
    const float* xr = x + (size_t)row * D_; float v[16], s = 0.f;
#pragma unroll
    for (int j = 0; j < 16; ++j) { v[j] = xr[lane + 64 * j]; s += v[j] * v[j]; }
    const float r = 1.0f / sqrtf(wsum(s) * (1.0f / D_) + 1e-6f);
#pragma unroll
    for (int j = 0; j < 16; ++j) { const float y = v[j] * r * g[lane + 64 * j]; if (res) res[(size_t)row * D_ + lane + 64 * j] += scale * y; else out[(size_t)row * D_ + lane + 64 * j] = y; }
}
__global__ void swiglu(float* __restrict__ G, const float* __restrict__ U, size_t n) {
    size_t i = (size_t)blockIdx.x * 256 + threadIdx.x; if (i >= n) return; const float g = G[i]; G[i] = g / (1.0f + expf(-g)) * U[i];
}
__global__ void gelu_uv(float* __restrict__ P, int rows) {
    size_t i = (size_t)blockIdx.x * 256 + threadIdx.x; if (i >= (size_t)rows * 1024) return; const size_t r = i >> 10, c = i & 1023; float* p = P + r * INC_ + c; const float v = *p; *p = 0.5f * v * (1.0f + erff(v * 0.70710678118654752f));
}
__global__ void ln_v(const float* __restrict__ P, const float* __restrict__ g, const float* __restrict__ b, float* __restrict__ VN, int rows) {
    const int row = blockIdx.x * 4 + (threadIdx.x >> 6), lane = threadIdx.x & 63; if (row >= rows) return;
    const float* v = P + (size_t)row * INC_ + 512; float x[8], s = 0.f;
#pragma unroll
    for (int j = 0; j < 8; ++j) { x[j] = v[lane + 64 * j]; s += x[j]; }
    const float mu = wsum(s) * (1.0f / 512); float q = 0.f;
#pragma unroll
    for (int j = 0; j < 8; ++j) { x[j] -= mu; q += x[j] * x[j]; }
    const float r = 1.0f / sqrtf(wsum(q) * (1.0f / 512) + 1e-5f);
#pragma unroll
    for (int j = 0; j < 8; ++j) VN[(size_t)row * 512 + lane + 64 * j] = x[j] * r * g[lane + 64 * j] + b[lane + 64 * j];
}
__global__ void spatial(const float* __restrict__ P, const float* __restrict__ VN, const float* __restrict__ ws, const float* __restrict__ bs, float* __restrict__ YC, int rows) {
    size_t i = (size_t)blockIdx.x * 256 + threadIdx.x; if (i >= (size_t)rows * 512) return; const int row = (int)(i >> 9), col = (int)(i & 511), h = col >> 6, m = row & 127, cb = row & ~127;
    const float* w = ws + ((size_t)h * 128 + m) * 128; float s = 0.f;
    for (int c = 0; c < 128; ++c) s += w[c] * VN[(size_t)(cb + c) * 512 + col];
    YC[(size_t)row * 1024 + col] = P[(size_t)row * INC_ + col] * (s + bs[h * 128 + m]);
}
__global__ void shortconv(const float* __restrict__ P, const float* __restrict__ w, const float* __restrict__ b, float* __restrict__ PB, int rows) {
    size_t i = (size_t)blockIdx.x * 256 + threadIdx.x; if (i >= (size_t)rows * 1536) return; const int row = (int)(i / 1536), ch = (int)(i % 1536), s = row & (SEQ_ - 1);
    float o = b[ch] + w[1536 + ch] * P[(size_t)row * INC_ + 1024 + ch];
    if (s > 0) o += w[ch] * P[(size_t)(row - 1) * INC_ + 1024 + ch];
    if (s < SEQ_ - 1) o += w[2 * 1536 + ch] * P[(size_t)(row + 1) * INC_ + 1024 + ch];
    PB[i] = o;
}
__global__ void filt_feat(float* __restrict__ Z) {
    const int n = blockIdx.x * 64 + threadIdx.x; if (n >= SEQ_) return;
    float* z = Z + n * 33; z[0] = (float)n / 2047.0f; const float c = (float)(2.0 * 3.14159265358979323846 / 2048.0);
    for (int j = 0; j < 16; ++j) { const float band = 1e-4f + (float)j * ((15.0f - 1e-4f) / 15.0f); const float ang = (c * (float)n) * band; z[1 + j] = cosf(ang); z[17 + j] = -sinf(ang); }
}
__global__ void filt_layer(const float* __restrict__ I, int nin, const float* __restrict__ W, const float* __restrict__ b, const float* __restrict__ freq, float* __restrict__ O) {
    const int i = blockIdx.x * 256 + threadIdx.x; if (i >= SEQ_ * 64) return; const int n = i >> 6, o = i & 63; float s = b[o];
    for (int k = 0; k < nin; ++k) s += I[n * nin + k] * W[k * 64 + o];
    O[i] = sinf(freq[o] * s);
}
__global__ void filt_fin(const float* __restrict__ HO, float* __restrict__ KF) {
    const size_t i = (size_t)blockIdx.x * 256 + threadIdx.x; if (i >= (size_t)2 * 4096 * 512) return; const int c = (int)(i & 511), m = (int)((i >> 9) & 4095), o = (int)(i >> 21);
    const int lag = m - 2048; float v = 0.f;
    if (m != 0) { const int j = lag < 0 ? -lag : lag, dir = lag < 0 ? 1 : 0;
        const float mind = logf(1e-2f) / 1.5f, maxd = logf(1e-2f) / 0.3f; const float delta = fabsf(mind + (float)c * ((maxd - mind) / 511.0f));
        v = HO[(size_t)j * 2048 + o * 1024 + dir * 512 + c] * expf(-((float)j / 2047.0f) * delta); }
    KF[i] = v;
}
__global__ void longconv(const float* __restrict__ U, int ldu, const float* __restrict__ KF, const float* __restrict__ skip, const float* __restrict__ gate, int ldg, float* __restrict__ OUT, int ldo, int rows) {
    size_t i = (size_t)blockIdx.x * 256 + threadIdx.x; if (i >= (size_t)rows * 512) return; const int row = (int)(i >> 9), c = (int)(i & 511), t = row & (SEQ_ - 1), rb = row - t;
    float acc = 0.f; const float* kf = KF + (size_t)(2048 + t) * 512 + c; const float* u = U + (size_t)rb * ldu + c;
    for (int s = 0; s < SEQ_; ++s) acc += kf[-(ptrdiff_t)s * 512] * u[(size_t)s * ldu];
    const float uu = U[(size_t)row * ldu + c];
    OUT[(size_t)row * ldo + c] = gate[(size_t)row * ldg + c] * (acc + skip[c] * uu);
}

struct Ptrs { const float* in[30]; };
static inline dim3 g1(size_t n) { return dim3((unsigned)((n + 255) / 256)); }
static void ffn(float* x, const float* pre_g, const float* wg, const float* wu, const float* wd, const float* post_g, float* ws, hipStream_t st) {
    float* H = ws; float* G = H + (size_t)CH_ * D_; float* U = G + (size_t)CH_ * FF_; float* Y = U + (size_t)CH_ * FF_;
    for (int m0 = 0; m0 < T_; m0 += CH_) {
        float* xc = x + (size_t)m0 * D_;
        rmsnorm<<<CH_ / 4, 256, 0, st>>>(xc, pre_g, H, nullptr, 0.f, CH_);
        gemm<<<dim3(FF_ / 64, CH_ / 64), 256, 0, st>>>(H, D_, wg, FF_, G, FF_, D_);
        gemm<<<dim3(FF_ / 64, CH_ / 64), 256, 0, st>>>(H, D_, wu, FF_, U, FF_, D_);
        swiglu<<<g1((size_t)CH_ * FF_), 256, 0, st>>>(G, U, (size_t)CH_ * FF_);
        gemm<<<dim3(D_ / 64, CH_ / 64), 256, 0, st>>>(G, FF_, wd, D_, Y, D_, FF_);
        rmsnorm<<<CH_ / 4, 256, 0, st>>>(Y, post_g, nullptr, xc, 0.5f, CH_);
    }
}
static void mixer(float* x, const Ptrs& p, int l, float* ws, hipStream_t st) {
    float* KF = ws; float* Z = KF + (size_t)2 * 4096 * 512; float* A1 = Z + 2048 * 33; float* A2 = A1 + 2048 * 64; float* HO = A2 + 2048 * 64; float* rest = HO + (size_t)2048 * 2048;
    filt_feat<<<SEQ_ / 64, 64, 0, st>>>(Z);
    filt_layer<<<SEQ_ * 64 / 256, 256, 0, st>>>(Z, 33, p.in[14] + (size_t)l * 33 * 64, p.in[15] + l * 64, p.in[20] + l * 64, A1);
    filt_layer<<<SEQ_ * 64 / 256, 256, 0, st>>>(A1, 64, p.in[16] + (size_t)l * 64 * 64, p.in[17] + l * 64, p.in[20] + l * 64, A2);
    filt_layer<<<SEQ_ * 64 / 256, 256, 0, st>>>(A2, 64, p.in[18] + (size_t)l * 64 * 64, p.in[19] + l * 64, p.in[20] + l * 64, A1);
    gemm<<<dim3(2048 / 64, 2048 / 64), 256, 0, st>>>(A1, 64, p.in[21] + (size_t)l * 64 * 2048, 2048, HO, 2048, 64);
    filt_fin<<<g1((size_t)2 * 4096 * 512), 256, 0, st>>>(HO, KF);
    float* H = rest; float* P = H + (size_t)CH_ * D_; float* VN = P + (size_t)CH_ * INC_; float* PB = VN + (size_t)CH_ * 512; float* YC = PB + (size_t)CH_ * 1536; float* Z1 = YC + (size_t)CH_ * 1024; float* Y = Z1 + (size_t)CH_ * 512;
    for (int m0 = 0; m0 < T_; m0 += CH_) {
        float* xc = x + (size_t)m0 * D_;
        rmsnorm<<<CH_ / 4, 256, 0, st>>>(xc, p.in[6] + l * D_, H, nullptr, 0.f, CH_);
        gemm<<<dim3(INC_ / 64, CH_ / 64), 256, 0, st>>>(H, D_, p.in[7] + (size_t)l * D_ * INC_, INC_, P, INC_, D_);
        gelu_uv<<<g1((size_t)CH_ * 1024), 256, 0, st>>>(P, CH_);
        ln_v<<<CH_ / 4, 256, 0, st>>>(P, p.in[8] + l * 512, p.in[9] + l * 512, VN, CH_);
        spatial<<<g1((size_t)CH_ * 512), 256, 0, st>>>(P, VN, p.in[10] + (size_t)l * 8 * 128 * 128, p.in[11] + l * 8 * 128, YC, CH_);
        shortconv<<<g1((size_t)CH_ * 1536), 256, 0, st>>>(P, p.in[12] + (size_t)l * 3 * 1536, p.in[13] + l * 1536, PB, CH_);
        longconv<<<g1((size_t)CH_ * 512), 256, 0, st>>>(PB, 1536, KF, p.in[22] + (size_t)l * 2 * 512, PB + 512, 1536, Z1, 512, CH_);
        longconv<<<g1((size_t)CH_ * 512), 256, 0, st>>>(Z1, 512, KF + (size_t)4096 * 512, p.in[22] + (size_t)l * 2 * 512 + 512, PB + 1024, 1536, YC + 512, 1024, CH_);
        gemm<<<dim3(D_ / 64, CH_ / 64), 256, 0, st>>>(YC, 1024, p.in[23] + (size_t)l * 1024 * 1024, D_, Y, D_, 1024);
        rmsnorm<<<CH_ / 4, 256, 0, st>>>(Y, p.in[24] + l * D_, nullptr, xc, 1.0f, CH_);
    }
}
static void run_blocks(float* x, const Ptrs& p, int b_lo, float* ws, hipStream_t st) {
    for (int b = b_lo; b < 6; ++b) { const int l = b / 3, k = b % 3;
        if (k == 0) ffn(x, p.in[1] + l * D_, p.in[2] + (size_t)l * D_ * FF_, p.in[3] + (size_t)l * D_ * FF_, p.in[4] + (size_t)l * FF_ * D_, p.in[5] + l * D_, ws, st);
        else if (k == 1) mixer(x, p, l, ws, st);
        else ffn(x, p.in[25] + l * D_, p.in[26] + (size_t)l * D_ * FF_, p.in[27] + (size_t)l * D_ * FF_, p.in[28] + (size_t)l * FF_ * D_, p.in[29] + l * D_, ws, st);
    }
}
}
extern "C" void kernel_launch(void* const* d_in, const int* in_sizes, int n_in, void* d_out, int out_size, void* d_ws, size_t ws_size, hipStream_t stream) {
    nv::Ptrs p; for (int i = 0; i < 30; ++i) p.in[i] = (const float*)d_in[i];
    (void)hipMemcpyAsync(d_out, d_in[0], (size_t)16384 * 1024 * 4, hipMemcpyDeviceToDevice, stream);
    nv::run_blocks((float*)d_out, p, 0, (float*)d_ws, stream);
}
```
